# Optimizing an MI355X kernel written in HIP

```python
import math
import jax, jax.numpy as jnp
from jax import lax
import numpy as np


D_MODEL = 1024
BATCH = 16
SEQ = 4096
DEPTH = 1

MIX_WIDTH = D_MODEL
SSD_WIDTH = MIX_WIDTH // 2
SSD_HEAD_DIM = 64
SSD_HEADS = SSD_WIDTH // SSD_HEAD_DIM
SSD_GROUPS = 2
SSD_STATE = 128
SSD_CONV = 4
SSD_CHUNK = 128
SSD_BC = SSD_GROUPS * SSD_STATE
CONV_CH = SSD_WIDTH + 2 * SSD_BC
S5_WIDTH = MIX_WIDTH - SSD_WIDTH
S5_GROUP_CH = 16
S5_GROUPS = S5_WIDTH // S5_GROUP_CH
S5_STATE = 64
IN_COLS = SSD_WIDTH + CONV_CH + SSD_HEADS + S5_WIDTH
D_FF = ((8 * D_MODEL // 3 + 255) // 256) * 256
N_MOD = 9
ALPHA = (2 * DEPTH) ** 0.25
BETA = (8 * DEPTH) ** -0.25
LN_EPS = 1e-5

kernel_name = 'hymba_ssd_s5_macaron_deepnorm'


def layer_norm(x, g, b):
    xf = x.astype(jnp.float32)
    mu = jnp.mean(xf, axis=-1, keepdims=True)
    var = jnp.mean(jnp.square(xf - mu), axis=-1, keepdims=True)
    return ((xf - mu) * lax.rsqrt(var + LN_EPS) * g + b).astype(x.dtype)


def modulate(x, shift, scale):
    return x * (1 + scale[:, None, :]) + shift[:, None, :]


def swiglu(u, w1, w3, w2):
    return (jax.nn.silu(u @ w1) * (u @ w3)) @ w2


def causal_dwconv(x, w, b):
    k = w.shape[0]
    y = lax.conv_general_dilated(x, w[:, None, :], window_strides=(1,), padding=[(k - 1, 0)],
                                 dimension_numbers=('NWC', 'WIO', 'NWC'),
                                 feature_group_count=x.shape[-1])
    return y + b


def ssd_chunked(xs, dt, a, bm, cm):
    bsz, s_len, n_h, p = xs.shape
    n_g, n_s = bm.shape[-2:]
    n_z = n_h // n_g
    l = SSD_CHUNK
    nc = s_len // l
    x = (xs * dt[..., None]).reshape(bsz, nc, l, n_g, n_z, p)
    a_dt = (dt * a).reshape(bsz, nc, l, n_g, n_z).transpose(0, 3, 4, 1, 2)
    bm = bm.reshape(bsz, nc, l, n_g, n_s)
    cm = cm.reshape(bsz, nc, l, n_g, n_s)
    a_cs = jnp.cumsum(a_dt, axis=-1)
    causal = jnp.tril(jnp.ones((l, l), dtype=bool))
    seg = a_cs[..., :, None] - a_cs[..., None, :]
    lmat = jnp.exp(jnp.where(causal, seg, -jnp.inf))
    cb = jnp.einsum('bclgn,bcsgn->bcgls', cm, bm)
    y_diag = jnp.einsum('bcgls,bgzcls,bcsgzp->bclgzp', cb, lmat, x)
    decay = jnp.exp(a_cs[..., -1:] - a_cs)
    states = jnp.einsum('bclgn,bgzcl,bclgzp->bcgzpn', bm, decay, x)
    chunk_decay = jnp.exp(a_cs[..., -1])

    def step(h, inp):
        s_c, d_c = inp
        return d_c[..., None, None] * h + s_c, h

    h0 = jnp.zeros((bsz, n_g, n_z, p, n_s), dtype=states.dtype)
    _, prev = lax.scan(step, h0, (jnp.moveaxis(states, 1, 0), jnp.moveaxis(chunk_decay, 3, 0)))
    prev = jnp.moveaxis(prev, 0, 1)
    y_off = jnp.einsum('bclgn,bcgzpn,bgzcl->bclgzp', cm, prev, jnp.exp(a_cs))
    return (y_diag + y_off).reshape(bsz, s_len, n_h, p)


def s5_mixer(u, a_re, a_im, log_dt, b_re, b_im, c_re, c_im, d, w_glu, b_glu):
    f32 = jnp.float32
    bsz, s_len, _ = u.shape
    uf = u.astype(f32).reshape(bsz, s_len, S5_GROUPS, S5_GROUP_CH)
    ar, ai = a_re.astype(f32), a_im.astype(f32)
    dt = jnp.exp(log_dt.astype(f32))[:, None]
    mag = jnp.exp(dt * ar)
    ab_re, ab_im = mag * jnp.cos(dt * ai), mag * jnp.sin(dt * ai)
    den = ar * ar + ai * ai
    nr, ni = ab_re - 1.0, ab_im
    f_re, f_im = (nr * ar + ni * ai) / den, (ni * ar - nr * ai) / den
    br, bi = b_re.astype(f32), b_im.astype(f32)
    bb_re = f_re[..., None] * br - f_im[..., None] * bi
    bb_im = f_re[..., None] * bi + f_im[..., None] * br
    bu_re = jnp.einsum('bsgh,gph->bsgp', uf, bb_re)
    bu_im = jnp.einsum('bsgh,gph->bsgp', uf, bb_im)
    a_seq_re = jnp.broadcast_to(ab_re, (1, s_len, S5_GROUPS, S5_STATE))
    a_seq_im = jnp.broadcast_to(ab_im, (1, s_len, S5_GROUPS, S5_STATE))

    def combine(e1, e2):
        a1r, a1i, b1r, b1i = e1
        a2r, a2i, b2r, b2i = e2
        return (a2r * a1r - a2i * a1i, a2r * a1i + a2i * a1r,
                a2r * b1r - a2i * b1i + b2r, a2r * b1i + a2i * b1r + b2i)

    _, _, xr, xi = lax.associative_scan(combine, (a_seq_re, a_seq_im, bu_re, bu_im), axis=1)
    y = (jnp.einsum('bsgp,ghp->bsgh', xr, c_re.astype(f32))
         - jnp.einsum('bsgp,ghp->bsgh', xi, c_im.astype(f32))
         + uf * d.astype(f32).reshape(S5_GROUPS, S5_GROUP_CH))
    y = y.reshape(bsz, s_len, S5_WIDTH)
    g = jax.nn.gelu(y)
    out = g * jax.nn.sigmoid(g @ w_glu.astype(f32) + b_glu.astype(f32))
    return out.astype(u.dtype)


def hybrid_mixer(h, w_in, conv_w, conv_b, dt_bias, a_log, d_ssd, ssd_norm_w,
                 s5_a_re, s5_a_im, s5_log_dt, s5_b_re, s5_b_im, s5_c_re, s5_c_im, s5_d,
                 w_glu, b_glu, w_out):
    f32 = jnp.float32
    bsz, s_len, _ = h.shape
    proj = h @ w_in
    z, xbc, dt_raw, u = jnp.split(proj, [SSD_WIDTH, SSD_WIDTH + CONV_CH,
                                         SSD_WIDTH + CONV_CH + SSD_HEADS], axis=-1)
    xbc = jax.nn.silu(causal_dwconv(xbc, conv_w, conv_b))
    xs, bm, cm = jnp.split(xbc.astype(f32), [SSD_WIDTH, SSD_WIDTH + SSD_BC], axis=-1)
    dt = jax.nn.softplus(dt_raw.astype(f32) + dt_bias.astype(f32))
    a = -jnp.exp(a_log.astype(f32))
    xs = xs.reshape(bsz, s_len, SSD_HEADS, SSD_HEAD_DIM)
    y = ssd_chunked(xs, dt, a,
                    bm.reshape(bsz, s_len, SSD_GROUPS, SSD_STATE),
                    cm.reshape(bsz, s_len, SSD_GROUPS, SSD_STATE))
    y = y + d_ssd.astype(f32)[:, None] * xs
    y = y.reshape(bsz, s_len, SSD_WIDTH) * jax.nn.silu(z.astype(f32))
    yg = y.reshape(bsz, s_len, SSD_GROUPS, SSD_WIDTH // SSD_GROUPS)
    yg = yg * lax.rsqrt(jnp.mean(jnp.square(yg), axis=-1, keepdims=True) + LN_EPS)
    y_ssd = (yg.reshape(bsz, s_len, SSD_WIDTH) * ssd_norm_w.astype(f32)).astype(h.dtype)
    y_s5 = s5_mixer(u, s5_a_re, s5_a_im, s5_log_dt, s5_b_re, s5_b_im, s5_c_re, s5_c_im,
                    s5_d, w_glu, b_glu)
    return jnp.concatenate([y_ssd, y_s5], axis=-1) @ w_out


def setup_inputs(seed: int = 0) -> dict:
    key = jax.random.key(seed)
    ks = iter(jax.random.split(key, 48))
    f32 = jnp.float32
    nl = DEPTH

    def nrm(shape, std):
        return std * jax.random.normal(next(ks), shape, f32)

    def unif(shape, lo, hi):
        return jax.random.uniform(next(ks), shape, f32, minval=lo, maxval=hi)

    x = nrm((BATCH, SEQ, D_MODEL), 1.0)
    c = nrm((BATCH, D_MODEL), 1.0)
    w_ada = nrm((nl, D_MODEL, N_MOD * D_MODEL), 0.5 * D_MODEL ** -0.5)
    b_ada = nrm((nl, N_MOD * D_MODEL), 0.02)
    ffn1_w1 = nrm((nl, D_MODEL, D_FF), D_MODEL ** -0.5)
    ffn1_w3 = nrm((nl, D_MODEL, D_FF), D_MODEL ** -0.5)
    ffn1_w2 = nrm((nl, D_FF, D_MODEL), BETA * D_FF ** -0.5)
    ln1_g = 1.0 + nrm((nl, D_MODEL), 0.02)
    ln1_b = nrm((nl, D_MODEL), 0.02)
    w_in = nrm((nl, D_MODEL, IN_COLS), D_MODEL ** -0.5)
    conv_w = nrm((nl, SSD_CONV, CONV_CH), SSD_CONV ** -0.5)
    conv_b = nrm((nl, CONV_CH), 0.01)
    dt0 = jnp.exp(unif((nl, SSD_HEADS), math.log(1e-3), math.log(1e-1)))
    dt_bias = dt0 + jnp.log(-jnp.expm1(-dt0))
    a_log = jnp.log(unif((nl, SSD_HEADS), 1.0, 16.0))
    d_ssd = 1.0 + nrm((nl, SSD_HEADS), 0.1)
    ssd_norm_w = 1.0 + nrm((nl, SSD_WIDTH), 0.02)
    s5_a_re = -0.5 + nrm((nl, S5_GROUPS, S5_STATE), 0.01)
    s5_a_im = math.pi * jnp.arange(S5_STATE, dtype=f32)[None, None, :] + nrm((nl, S5_GROUPS, S5_STATE), 0.01)
    s5_log_dt = unif((nl, S5_GROUPS), math.log(1e-3), math.log(1e-1))
    s5_b_re = nrm((nl, S5_GROUPS, S5_STATE, S5_GROUP_CH), (2 * S5_GROUP_CH) ** -0.5)
    s5_b_im = nrm((nl, S5_GROUPS, S5_STATE, S5_GROUP_CH), (2 * S5_GROUP_CH) ** -0.5)
    s5_c_re = nrm((nl, S5_GROUPS, S5_GROUP_CH, S5_STATE), S5_STATE ** -0.5)
    s5_c_im = nrm((nl, S5_GROUPS, S5_GROUP_CH, S5_STATE), S5_STATE ** -0.5)
    s5_d = nrm((nl, S5_WIDTH), 1.0)
    w_glu = nrm((nl, S5_WIDTH, S5_WIDTH), S5_WIDTH ** -0.5)
    b_glu = nrm((nl, S5_WIDTH), 0.01)
    w_out = nrm((nl, MIX_WIDTH, D_MODEL), BETA * MIX_WIDTH ** -0.5)
    ln2_g = 1.0 + nrm((nl, D_MODEL), 0.02)
    ln2_b = nrm((nl, D_MODEL), 0.02)
    ffn2_w1 = nrm((nl, D_MODEL, D_FF), D_MODEL ** -0.5)
    ffn2_w3 = nrm((nl, D_MODEL, D_FF), D_MODEL ** -0.5)
    ffn2_w2 = nrm((nl, D_FF, D_MODEL), BETA * D_FF ** -0.5)
    ln3_g = 1.0 + nrm((nl, D_MODEL), 0.02)
    ln3_b = nrm((nl, D_MODEL), 0.02)
    return {'x': x, 'c': c, 'w_ada': w_ada, 'b_ada': b_ada,
            'ffn1_w1': ffn1_w1, 'ffn1_w3': ffn1_w3, 'ffn1_w2': ffn1_w2, 'ln1_g': ln1_g, 'ln1_b': ln1_b,
            'w_in': w_in, 'conv_w': conv_w, 'conv_b': conv_b, 'dt_bias': dt_bias, 'a_log': a_log,
            'd_ssd': d_ssd, 'ssd_norm_w': ssd_norm_w, 's5_a_re': s5_a_re, 's5_a_im': s5_a_im,
            's5_log_dt': s5_log_dt, 's5_b_re': s5_b_re, 's5_b_im': s5_b_im, 's5_c_re': s5_c_re,
            's5_c_im': s5_c_im, 's5_d': s5_d, 'w_glu': w_glu, 'b_glu': b_glu, 'w_out': w_out,
            'ln2_g': ln2_g, 'ln2_b': ln2_b, 'ffn2_w1': ffn2_w1, 'ffn2_w3': ffn2_w3, 'ffn2_w2': ffn2_w2,
            'ln3_g': ln3_g, 'ln3_b': ln3_b}


def reference(x, c, w_ada, b_ada, ffn1_w1, ffn1_w3, ffn1_w2, ln1_g, ln1_b,
              w_in, conv_w, conv_b, dt_bias, a_log, d_ssd, ssd_norm_w, s5_a_re, s5_a_im,
              s5_log_dt, s5_b_re, s5_b_im, s5_c_re, s5_c_im, s5_d, w_glu, b_glu, w_out,
              ln2_g, ln2_b, ffn2_w1, ffn2_w3, ffn2_w2, ln3_g, ln3_b):
    bsz = x.shape[0]
    cs = jax.nn.silu(c)
    for l in range(DEPTH):
        mod = (cs @ w_ada[l] + b_ada[l]).reshape(bsz, N_MOD, D_MODEL)
        sh1, sc1, g1 = mod[:, 0], mod[:, 1], mod[:, 2]
        sh2, sc2, g2 = mod[:, 3], mod[:, 4], mod[:, 5]
        sh3, sc3, g3 = mod[:, 6], mod[:, 7], mod[:, 8]
        h = modulate(x, sh1, sc1)
        x = layer_norm(ALPHA * x + 0.5 * g1[:, None, :] * swiglu(h, ffn1_w1[l], ffn1_w3[l], ffn1_w2[l]),
                       ln1_g[l], ln1_b[l])
        h = modulate(x, sh2, sc2)
        m = hybrid_mixer(h, w_in[l], conv_w[l], conv_b[l], dt_bias[l], a_log[l], d_ssd[l],
                         ssd_norm_w[l], s5_a_re[l], s5_a_im[l], s5_log_dt[l], s5_b_re[l],
                         s5_b_im[l], s5_c_re[l], s5_c_im[l], s5_d[l], w_glu[l], b_glu[l], w_out[l])
        x = layer_norm(ALPHA * x + g2[:, None, :] * m, ln2_g[l], ln2_b[l])
        h = modulate(x, sh3, sc3)
        x = layer_norm(ALPHA * x + 0.5 * g3[:, None, :] * swiglu(h, ffn2_w1[l], ffn2_w3[l], ffn2_w2[l]),
                       ln3_g[l], ln3_b[l])
    return x
```

```cpp
#include <hip/hip_runtime.h>
#include <hip/hip_cooperative_groups.h>
#include <cstdio>
namespace cg = cooperative_groups;

#define LAS __attribute__((address_space(3)))
typedef unsigned short bf16_t;
typedef short bf16x8 __attribute__((ext_vector_type(8)));
typedef float f32x4 __attribute__((ext_vector_type(4)));
typedef float f32x2 __attribute__((ext_vector_type(2)));
typedef unsigned u32x4 __attribute__((ext_vector_type(4)));
typedef unsigned u32x2 __attribute__((ext_vector_type(2)));

constexpr int MT = 65536, DM = 1024, FF = 2816, SEQ = 4096;
constexpr float ALPHA = 1.189207115002721f;
constexpr float LN_EPS = 1e-5f;
constexpr int LDS_BYTES = 159 * 1024;

constexpr size_t WS_MOD   = 0;
constexpr size_t WS_S5AL  = 640 * 1024;
constexpr size_t WS_CD    = 704 * 1024;
constexpr size_t WS_W13A  = 1u << 20;
constexpr size_t WS_W2A   = WS_W13A + 5632ull * 1024 * 2;
constexpr size_t WS_W13B  = WS_W2A + 1024ull * 2816 * 2;
constexpr size_t WS_W2B   = WS_W13B + 5632ull * 1024 * 2;
constexpr size_t WS_WIN   = WS_W2B + 1024ull * 2816 * 2;
constexpr size_t WS_WOUT  = WS_WIN + 2304ull * 1024 * 2;
constexpr size_t WS_WGLU  = WS_WOUT + 1024ull * 1024 * 2;
constexpr size_t WS_S5T   = WS_WGLU + 512ull * 512 * 2;
constexpr size_t WS_S5WS  = WS_S5T + 32ull * 512 * 640 * 2;
constexpr size_t WS_H     = WS_S5WS + 32ull * 256 * 512 * 2;
constexpr size_t WS_ACT   = WS_H + (size_t)MT * 1024 * 2;
constexpr size_t WS_X     = WS_ACT + (size_t)MT * 2816 * 2;
constexpr size_t WS_DT    = WS_X + (size_t)MT * 1024 * 4;
constexpr size_t WS_S5S   = WS_DT + (size_t)MT * 8 * 4;
constexpr size_t WS_END   = WS_S5S + 32ull * 2048 * 128 * 4;
constexpr size_t WS_Z     = WS_ACT;
constexpr size_t WS_XBC   = WS_Z + (size_t)MT * 512 * 2;
constexpr size_t WS_UX    = WS_XBC + (size_t)MT * 1024 * 2;
constexpr size_t WS_G     = WS_UX + 32ull * 2048 * 640 * 2;
static_assert(WS_G + (size_t)MT * 512 * 2 <= WS_X, "mixer intermediates must fit in ACT");
static_assert(WS_END <= (1ull << 30), "workspace over 1 GiB");
constexpr size_t OUT_STATES = 0, OUT_PREV = 16ull * 32 * 8 * 8192 * 4;

struct Params {
    const float* in[34];
    float* out;
    unsigned char* ws;
};

typedef const Params __attribute__((address_space(4)))* KP;
__device__ __forceinline__ KP launder(KP p) { asm volatile("" : "+s"(p)); return p; }
__device__ __forceinline__ int tid_l() { int t = threadIdx.x; asm volatile("" : "+v"(t)); return t; }
__device__ __forceinline__ unsigned cvt_pk_bf16(float lo, float hi) { unsigned r; asm("v_cvt_pk_bf16_f32 %0, %1, %2" : "=v"(r) : "v"(lo), "v"(hi)); return r; }
__device__ __forceinline__ bf16_t f2bf(float v) { return (bf16_t)(cvt_pk_bf16(v, 0.f) & 0xffffu); }
__device__ __forceinline__ float bf_lo(unsigned u) { return __uint_as_float(u << 16); }
__device__ __forceinline__ float bf_hi(unsigned u) { return __uint_as_float(u & 0xffff0000u); }
__device__ __forceinline__ float sigm(float x) { return __frcp_rn(1.0f + __expf(-x)); }
__device__ __forceinline__ float siluf(float x) { return x * sigm(x); }
__device__ __forceinline__ float gelu_tanh(float x) { return x * sigm(1.5957691216057308f * (x + 0.044715f * x * x * x)); }
__device__ __forceinline__ float wave_sum(float v) {
    v += __shfl_xor(v, 32); v += __shfl_xor(v, 16); v += __shfl_xor(v, 8); v += __shfl_xor(v, 4); v += __shfl_xor(v, 2); v += __shfl_xor(v, 1); return v;
}
__device__ __forceinline__ void sincos_d(double x, double& s, double& c) {
    const double k = rint(x * 0.63661977236758134308);
    double r = fma(-k, 1.57079632679489655800e+00, x); r = fma(-k, 6.12323399573676603587e-17, r);
    const int q = (int)((long long)k & 3);
    const double r2 = r * r;
    double sp = 1.0 / 6227020800.0; sp = fma(sp, r2, -1.0 / 39916800.0); sp = fma(sp, r2, 1.0 / 362880.0); sp = fma(sp, r2, -1.0 / 5040.0); sp = fma(sp, r2, 1.0 / 120.0); sp = fma(sp, r2, -1.0 / 6.0); sp = fma(sp * r2, r, r);
    double cp = -1.0 / 87178291200.0; cp = fma(cp, r2, 1.0 / 479001600.0); cp = fma(cp, r2, -1.0 / 3628800.0); cp = fma(cp, r2, 1.0 / 40320.0); cp = fma(cp, r2, -1.0 / 720.0); cp = fma(cp, r2, 1.0 / 24.0); cp = fma(cp, r2, -0.5); cp = fma(cp, r2, 1.0);
    s = (q == 0) ? sp : (q == 1) ? cp : (q == 2) ? -sp : -cp;
    c = (q == 0) ? cp : (q == 1) ? -sp : (q == 2) ? -cp : sp;
}

namespace pg8 {
constexpr int BM = 256, BK = 64, HALF = 128, HTB = HALF * BK * 2, NXCD = 8, WGM = 8;
__device__ __forceinline__ int lds_byte(int r, int c) { const int st = (r >> 4) * 2 + (c >> 5), rr = r & 15, cc = c & 31, ob = rr * 64 + cc * 2; return st * 1024 + (ob ^ (((ob >> 9) & 1) << 5)); }
__device__ __forceinline__ void stage_rc(int b, int& R, int& C) { const int st = b / 1024, sb = b % 1024, swz = sb ^ (((sb >> 9) & 1) << 5); R = (st >> 1) * 16 + swz / 64; C = (st & 1) * 32 + (swz % 64) / 2; }
__device__ __forceinline__ int perm32(int rho) { const int n = rho >> 4, i = rho & 15; return 8 * (i >> 2) + 4 * n + (i & 3); }

struct Unit { int pm, pn, g; };
struct Gemm { const bf16_t* A; const bf16_t* Bt; int lda, ldb, K, nM, nN, ng; size_t gsA, gsB; };

__device__ __forceinline__ bool next_unit(const Gemm& g, int i, Unit& u) {
    const int per = g.nM * g.nN, nwg = per * g.ng;
    const long L = (long)i * gridDim.x + blockIdx.x; if (L >= nwg) return false;
    int wgid = (int)L; { const int q = nwg / NXCD, r = nwg % NXCD, xcd = wgid % NXCD, off = wgid / NXCD; wgid = (xcd < r ? xcd * (q + 1) : r * (q + 1) + (xcd - r) * q) + off; }
    u.g = wgid / per; const int w = wgid % per;
    const int nig = WGM * g.nN, gid = w / nig, fm = gid * WGM, gsz = (g.nM - fm) < WGM ? (g.nM - fm) : WGM;
    u.pm = fm + ((w % nig) % gsz); u.pn = (w % nig) / gsz; return true;
}

template <class Epi>
__device__ __forceinline__ void gemm_phase(LAS unsigned char* lds, const Gemm g, const Epi& E) {
    const int tid = tid_l(), wid = __builtin_amdgcn_readfirstlane(tid >> 6), lane = tid & 63, wr = wid >> 2, wc = wid & 3, fr = lane & 15, fq = lane >> 4;
    const int K = g.K, nt = K / BK;
    unsigned voffA[2], voffB[2];
#pragma unroll
    for (int i = 0; i < 2; ++i) { int R, C; stage_rc(tid * 16 + i * 8192, R, C); const int Rb = Epi::PERM ? ((R & ~31) + perm32(R & 31)) : R;
        voffA[i] = (unsigned)(R * g.lda + C) * 2u; voffB[i] = (unsigned)(Rb * g.ldb + C) * 2u; }
    const size_t kstep = (size_t)(BK * 2);
    const size_t hstepA = (size_t)HALF * g.lda * 2, hstepB = (size_t)HALF * g.ldb * 2;
    const size_t tstepA = 2 * hstepA, tstepB = 2 * hstepB;
    const unsigned ldsw = (unsigned)wid * 1024u;
    const int aoff = lds_byte(wr * 64 + fr, fq * 8), boff = lds_byte(wc * 32 + fr, fq * 8);
#define PG8_SA(b, h) (((b) * 2 + (h)) * HTB)
#define PG8_SB(b, h) ((4 + (b) * 2 + (h)) * HTB)
#define PG8_STAGE(bufoff, gbase, voff) do { _Pragma("unroll") for (int _i = 0; _i < 2; ++_i) \
        __builtin_amdgcn_global_load_lds((const unsigned*)((const char*)(gbase) + (voff)[_i]), (LAS unsigned*)(lds + (bufoff) + ldsw + _i * 8192), 16, 0, 0); } while (0)
#define PG8_LDA(dst, b, h) do { _Pragma("unroll") for (int m = 0; m < 4; ++m) _Pragma("unroll") for (int k = 0; k < 2; ++k) dst[m][k] = *(const LAS bf16x8*)(lds + PG8_SA(b, h) + aoff + m * 2048 + k * 1024); } while (0)
#define PG8_LDB(dst, b, h) do { _Pragma("unroll") for (int n = 0; n < 2; ++n) _Pragma("unroll") for (int k = 0; k < 2; ++k) dst[n][k] = *(const LAS bf16x8*)(lds + PG8_SB(b, h) + boff + n * 2048 + k * 1024); } while (0)
#define PG8_MMA(ai, bj, At, Bt) do { __builtin_amdgcn_s_setprio(1); _Pragma("unroll") for (int m = 0; m < 4; ++m) _Pragma("unroll") for (int n = 0; n < 2; ++n) _Pragma("unroll") for (int k = 0; k < 2; ++k) \
        acc[ai][bj][m][n] = __builtin_amdgcn_mfma_f32_16x16x32_bf16(Bt[n][k], At[m][k], acc[ai][bj][m][n], 0, 0, 0); __builtin_amdgcn_s_setprio(0); } while (0)
#define PG8_WAIT_V(n) asm volatile("s_waitcnt vmcnt(" #n ")" ::: "memory")
#define PG8_WAIT_L(n) asm volatile("s_waitcnt lgkmcnt(" #n ")" ::: "memory")
#define PG8_BAR __builtin_amdgcn_s_barrier()
#define PG8_SCHED __builtin_amdgcn_sched_barrier(0)
    Unit cur, nxt; int ui = 0;
    if (!next_unit(g, 0, cur)) return;
    f32x4 acc[2][2][4][2];
#pragma unroll
    for (int a = 0; a < 2; ++a)
#pragma unroll
        for (int b = 0; b < 2; ++b)
#pragma unroll
            for (int m = 0; m < 4; ++m)
#pragma unroll
                for (int n = 0; n < 2; ++n) acc[a][b][m][n] = (f32x4){0.f, 0.f, 0.f, 0.f};
    bf16x8 At[4][2], B0[2][2], B1[2][2];
    const char* cA = (const char*)g.A + ((size_t)cur.g * g.gsA) * 2 + (size_t)cur.pm * tstepA;
    const char* cB = (const char*)g.Bt + ((size_t)cur.g * g.gsB) * 2 + (size_t)cur.pn * tstepB;
    PG8_STAGE(PG8_SB(0, 0), cB, voffB); PG8_STAGE(PG8_SA(0, 0), cA, voffA); PG8_STAGE(PG8_SB(0, 1), cB + hstepB, voffB); PG8_STAGE(PG8_SA(0, 1), cA + hstepA, voffA);
    if (wr == 1) PG8_BAR;
    PG8_WAIT_V(4); PG8_BAR;
    PG8_STAGE(PG8_SB(1, 0), cB + kstep, voffB); PG8_STAGE(PG8_SA(1, 0), cA + kstep, voffA); PG8_STAGE(PG8_SB(1, 1), cB + hstepB + kstep, voffB);
    PG8_WAIT_V(6); PG8_BAR;
    for (;;) {
        const bool has_next = next_unit(g, ui + 1, nxt);
        const char* nA = has_next ? (const char*)g.A + ((size_t)nxt.g * g.gsA) * 2 + (size_t)nxt.pm * tstepA : cA;
        const char* nB = has_next ? (const char*)g.Bt + ((size_t)nxt.g * g.gsB) * 2 + (size_t)nxt.pn * tstepB : cB;
        for (int t = 0; t < nt; t += 2) {
            const bool last = (t == nt - 2);
            const char* a1 = cA + (size_t)(t + 1) * kstep;
            const char* a2 = last ? nA : cA + (size_t)(t + 2) * kstep; const char* b2 = last ? nB : cB + (size_t)(t + 2) * kstep;
            const char* a3 = a2 + kstep; const char* b3 = b2 + kstep;
            PG8_LDB(B0, 0, 0); PG8_SCHED; PG8_LDA(At, 0, 0); PG8_STAGE(PG8_SA(1, 1), a1 + hstepA, voffA);
            PG8_WAIT_L(8); PG8_BAR; PG8_WAIT_L(0); PG8_MMA(0, 0, At, B0); PG8_BAR; PG8_SCHED;
            PG8_LDB(B1, 0, 1); PG8_STAGE(PG8_SB(0, 0), b2, voffB);
            PG8_BAR; PG8_WAIT_L(0); PG8_MMA(0, 1, At, B1); PG8_BAR;
            PG8_LDA(At, 0, 1); PG8_STAGE(PG8_SA(0, 0), a2, voffA);
            PG8_BAR; PG8_WAIT_L(0); PG8_MMA(1, 0, At, B0); PG8_BAR; PG8_SCHED;
            PG8_STAGE(PG8_SB(0, 1), b2 + hstepB, voffB);
            PG8_WAIT_V(6); PG8_BAR; PG8_MMA(1, 1, At, B1); PG8_BAR;
            PG8_LDB(B0, 1, 0); PG8_SCHED; PG8_LDA(At, 1, 0); PG8_STAGE(PG8_SA(0, 1), a2 + hstepA, voffA);
            PG8_WAIT_L(8); PG8_BAR; PG8_WAIT_L(0); PG8_MMA(0, 0, At, B0); PG8_BAR; PG8_SCHED;
            PG8_LDB(B1, 1, 1); PG8_STAGE(PG8_SB(1, 0), b3, voffB);
            PG8_BAR; PG8_WAIT_L(0); PG8_MMA(0, 1, At, B1); PG8_BAR;
            PG8_LDA(At, 1, 1); PG8_STAGE(PG8_SA(1, 0), a3, voffA);
            PG8_BAR; PG8_WAIT_L(0); PG8_MMA(1, 0, At, B0); PG8_BAR; PG8_SCHED;
            PG8_STAGE(PG8_SB(1, 1), b3 + hstepB, voffB);
            PG8_WAIT_V(6); PG8_BAR; PG8_MMA(1, 1, At, B1); PG8_BAR;
        }
        E(acc, cur, wr, wc, fr, fq);
        if (!has_next) break;
#pragma unroll
        for (int a = 0; a < 2; ++a)
#pragma unroll
            for (int b = 0; b < 2; ++b)
#pragma unroll
                for (int m = 0; m < 4; ++m)
#pragma unroll
                    for (int n = 0; n < 2; ++n) acc[a][b][m][n] = (f32x4){0.f, 0.f, 0.f, 0.f};
        cur = nxt; cA = nA; cB = nB; ++ui;
    }
    PG8_WAIT_V(0);
    if (wr == 0) PG8_BAR;
    PG8_BAR;
#undef PG8_SA
#undef PG8_SB
#undef PG8_STAGE
#undef PG8_LDA
#undef PG8_LDB
#undef PG8_MMA
#undef PG8_WAIT_V
#undef PG8_WAIT_L
#undef PG8_BAR
#undef PG8_SCHED
}

struct EpiSwiGLU {
    static constexpr bool PERM = true;
    bf16_t* O;
    __device__ __forceinline__ void operator()(const f32x4 (&acc)[2][2][4][2], const Unit& u, int wr, int wc, int fr, int fq) const {
        const int row0 = u.pm * BM + wr * 64 + fr, col0 = u.pn * 128 + wc * 32 + 8 * fq;
#pragma unroll
        for (int ai = 0; ai < 2; ++ai)
#pragma unroll
            for (int m = 0; m < 4; ++m) {
                float a[8];
#pragma unroll
                for (int n = 0; n < 2; ++n)
#pragma unroll
                    for (int j = 0; j < 4; ++j) a[n * 4 + j] = siluf(acc[ai][0][m][n][j]) * acc[ai][1][m][n][j];
                u32x4 w; w.x = cvt_pk_bf16(a[0], a[1]); w.y = cvt_pk_bf16(a[2], a[3]); w.z = cvt_pk_bf16(a[4], a[5]); w.w = cvt_pk_bf16(a[6], a[7]);
                *(u32x4*)(O + (size_t)(row0 + ai * HALF + m * 16) * FF + col0) = w;
            }
    }
};
struct EpiResid {
    static constexpr bool PERM = false;
    float* Y; const float* res; const float* gate; float gs;
    __device__ __forceinline__ void operator()(const f32x4 (&acc)[2][2][4][2], const Unit& u, int wr, int wc, int fr, int fq) const {
        const int row0 = u.pm * BM + wr * 64 + fr, col0 = u.pn * BM + wc * 32 + 4 * fq;
        const float* gp = gate + (size_t)(u.pm >> 4) * 9216 + col0;
        f32x4 gv[2][2];
#pragma unroll
        for (int bj = 0; bj < 2; ++bj)
#pragma unroll
            for (int n = 0; n < 2; ++n) gv[bj][n] = *(const f32x4*)(gp + bj * HALF + n * 16) * gs;
#pragma unroll
        for (int ai = 0; ai < 2; ++ai)
#pragma unroll
            for (int m = 0; m < 4; ++m) {
                const size_t ro = (size_t)(row0 + ai * HALF + m * 16) * DM + col0;
#pragma unroll
                for (int bj = 0; bj < 2; ++bj)
#pragma unroll
                    for (int n = 0; n < 2; ++n) { const f32x4 xr = *(const f32x4*)(res + ro + bj * HALF + n * 16); *(f32x4*)(Y + ro + bj * HALF + n * 16) = xr * ALPHA + gv[bj][n] * acc[ai][bj][m][n]; }
            }
    }
};
struct EpiInProj {
    static constexpr bool PERM = true;
    bf16_t* Z; bf16_t* XBC; bf16_t* UX; float* DT;
    __device__ __forceinline__ void operator()(const f32x4 (&acc)[2][2][4][2], const Unit& u, int wr, int wc, int fr, int fq) const {
        const int row0 = u.pm * BM + wr * 64 + fr;
        if (u.pn == 8) {
            if (wc == 0 && fq == 0) {
#pragma unroll
                for (int ai = 0; ai < 2; ++ai)
#pragma unroll
                    for (int m = 0; m < 4; ++m) { float* p = DT + (size_t)(row0 + ai * HALF + m * 16) * 8; *(f32x4*)p = acc[ai][0][m][0]; *(f32x4*)(p + 4) = acc[ai][0][m][1]; }
            }
            return;
        }
#pragma unroll
        for (int ai = 0; ai < 2; ++ai)
#pragma unroll
            for (int m = 0; m < 4; ++m) {
                const int row = row0 + ai * HALF + m * 16;
#pragma unroll
                for (int bj = 0; bj < 2; ++bj) {
                    const f32x4 v0 = acc[ai][bj][m][0], v1 = acc[ai][bj][m][1];
                    u32x4 w; w.x = cvt_pk_bf16(v0[0], v0[1]); w.y = cvt_pk_bf16(v0[2], v0[3]); w.z = cvt_pk_bf16(v1[0], v1[1]); w.w = cvt_pk_bf16(v1[2], v1[3]);
                    const int cl = bj * HALF + wc * 32 + 8 * fq;
                    bf16_t* dst;
                    if (u.pn < 2) dst = Z + (size_t)row * 512 + u.pn * 256 + cl;
                    else if (u.pn < 6) dst = XBC + (size_t)row * 1024 + (u.pn - 2) * 256 + cl;
                    else { const int cu = (u.pn - 6) * 256 + cl; dst = UX + ((size_t)((cu >> 4) * 2048 + (row >> 5)) * 640 + (row & 31) * 16 + (cu & 15)); }
                    *(u32x4*)dst = w;
                }
            }
    }
};
struct EpiS5S {
    static constexpr bool PERM = false;
    float* S;
    __device__ __forceinline__ void operator()(const f32x4 (&acc)[2][2][4][2], const Unit& u, int wr, int wc, int fr, int fq) const {
        const int row0 = u.pm * BM + wr * 64 + fr, col0 = wc * 32 + 4 * fq;
#pragma unroll
        for (int ai = 0; ai < 2; ++ai)
#pragma unroll
            for (int m = 0; m < 4; ++m) { float* p = S + ((size_t)u.g * 2048 + row0 + ai * HALF + m * 16) * 128 + col0;
#pragma unroll
                for (int n = 0; n < 2; ++n) *(f32x4*)(p + n * 16) = acc[ai][0][m][n]; }
    }
};
struct EpiS5Main {
    static constexpr bool PERM = true;
    bf16_t* G;
    __device__ __forceinline__ void operator()(const f32x4 (&acc)[2][2][4][2], const Unit& u, int wr, int wc, int fr, int fq) const {
        const int row0 = u.pm * BM + wr * 64 + fr;
#pragma unroll
        for (int ai = 0; ai < 2; ++ai)
#pragma unroll
            for (int m = 0; m < 4; ++m) {
                const int rc = row0 + ai * HALF + m * 16;
#pragma unroll
                for (int bj = 0; bj < 2; ++bj) {
                    const int n0 = u.pn * BM + bj * HALF + wc * 32 + 8 * fq; const int l = n0 >> 4, h = n0 & 15;
                    float a[8];
#pragma unroll
                    for (int n = 0; n < 2; ++n)
#pragma unroll
                        for (int j = 0; j < 4; ++j) a[n * 4 + j] = gelu_tanh(acc[ai][bj][m][n][j]);
                    u32x4 w; w.x = cvt_pk_bf16(a[0], a[1]); w.y = cvt_pk_bf16(a[2], a[3]); w.z = cvt_pk_bf16(a[4], a[5]); w.w = cvt_pk_bf16(a[6], a[7]);
                    *(u32x4*)(G + ((size_t)rc * 32 + l) * 512 + u.g * 16 + h) = w;
                }
            }
    }
};
struct EpiGLU {
    static constexpr bool PERM = true;
    const bf16_t* G; const float* bias; bf16_t* YC;
    __device__ __forceinline__ void operator()(const f32x4 (&acc)[2][2][4][2], const Unit& u, int wr, int wc, int fr, int fq) const {
        const int row0 = u.pm * BM + wr * 64 + fr, col0 = u.pn * BM + wc * 32 + 8 * fq;
        f32x4 bv[2][2];
#pragma unroll
        for (int bj = 0; bj < 2; ++bj)
#pragma unroll
            for (int n = 0; n < 2; ++n) bv[bj][n] = *(const f32x4*)(bias + col0 + bj * HALF + 4 * n);
#pragma unroll
        for (int ai = 0; ai < 2; ++ai)
#pragma unroll
            for (int m = 0; m < 4; ++m) {
                const int row = row0 + ai * HALF + m * 16;
#pragma unroll
                for (int bj = 0; bj < 2; ++bj) {
                    const u32x4 gv = *(const u32x4*)(G + (size_t)row * 512 + col0 + bj * HALF);
                    const f32x4 v0 = acc[ai][bj][m][0] + bv[bj][0], v1 = acc[ai][bj][m][1] + bv[bj][1];
                    u32x4 w;
                    w.x = cvt_pk_bf16(bf_lo(gv.x) * sigm(v0[0]), bf_hi(gv.x) * sigm(v0[1]));
                    w.y = cvt_pk_bf16(bf_lo(gv.y) * sigm(v0[2]), bf_hi(gv.y) * sigm(v0[3]));
                    w.z = cvt_pk_bf16(bf_lo(gv.z) * sigm(v1[0]), bf_hi(gv.z) * sigm(v1[1]));
                    w.w = cvt_pk_bf16(bf_lo(gv.w) * sigm(v1[2]), bf_hi(gv.w) * sigm(v1[3]));
                    *(u32x4*)(YC + (size_t)row * 1024 + 512 + col0 + bj * HALF) = w;
                }
            }
    }
};
}

__device__ __forceinline__ void phase0(KP P, float* L) {
    const int tid = tid_l();
    unsigned char* ws = P->ws;
    constexpr int NMOD = 144, NTR = 5120, NS5 = 1056;
    for (int it = blockIdx.x; it < NMOD + NTR + NS5; it += gridDim.x) {
        if (it < NMOD) {
            float* cs = L; float* red = L + 16384;
            for (int i = tid; i < 16384; i += 512) { const float v = P->in[1][i]; cs[i] = v / (1.0f + expf(-v)); }
            __syncthreads();
            const int ks = tid >> 6, jj = tid & 63, col = it * 64 + jj;
            float acc[16];
#pragma unroll
            for (int b = 0; b < 16; ++b) acc[b] = 0.f;
            const float* wa = P->in[2];
            for (int k = ks * 128; k < ks * 128 + 128; ++k) { const float w = wa[(size_t)k * 9216 + col];
#pragma unroll
                for (int b = 0; b < 16; ++b) acc[b] = fmaf(cs[b * 1024 + k], w, acc[b]); }
#pragma unroll
            for (int b = 0; b < 16; ++b) red[(ks * 16 + b) * 64 + jj] = acc[b];
            __syncthreads();
            float* MOD = (float*)(ws + WS_MOD);
            for (int o = tid; o < 1024; o += 512) { const int b = o >> 6, j = o & 63; float s = P->in[3][it * 64 + j];
#pragma unroll
                for (int k8 = 0; k8 < 8; ++k8) s += red[(k8 * 16 + b) * 64 + j];
                MOD[b * 9216 + it * 64 + j] = s; }
        } else if (it < NMOD + NTR) {
            const int t = it - NMOD;
            int seg, loc;
            if (t < 1408) { seg = 0; loc = t; } else if (t < 2816) { seg = 1; loc = t - 1408; } else if (t < 3520) { seg = 2; loc = t - 2816; } else if (t < 4224) { seg = 3; loc = t - 3520; }
            else if (t < 4800) { seg = 4; loc = t - 4224; } else if (t < 5056) { seg = 5; loc = t - 4800; } else { seg = 6; loc = t - 5056; }
            const int K = (seg == 2 || seg == 3) ? 2816 : (seg == 6 ? 512 : 1024), nkt = K / 64;
            const int rt = loc / nkt, kt = loc % nkt;
            const int r = rt * 64 + (tid & 63);
            const float* src; int ld, col; bf16_t* dst;
            if (seg < 2) { const int pn = r >> 8, half = (r >> 7) & 1; col = pn * 128 + (r & 127); src = seg == 0 ? (half ? P->in[5] : P->in[4]) : (half ? P->in[30] : P->in[29]); ld = 2816; dst = (bf16_t*)(ws + (seg == 0 ? WS_W13A : WS_W13B)); }
            else if (seg < 4) { col = r; src = seg == 2 ? P->in[6] : P->in[31]; ld = 1024; dst = (bf16_t*)(ws + (seg == 2 ? WS_W2A : WS_W2B)); }
            else if (seg == 4) { col = r < 1536 ? r : (r < 2048 ? r + 8 : (r < 2056 ? r - 512 : -1)); src = P->in[9]; ld = 2056; dst = (bf16_t*)(ws + WS_WIN); }
            else if (seg == 5) { col = r; src = P->in[26]; ld = 1024; dst = (bf16_t*)(ws + WS_WOUT); }
            else { col = r; src = P->in[24]; ld = 512; dst = (bf16_t*)(ws + WS_WGLU); }
            float* tile = L;
#pragma unroll
            for (int i = 0; i < 8; ++i) { const int k = (tid >> 6) + 8 * i; tile[k * 65 + (tid & 63)] = col >= 0 ? src[(size_t)(kt * 64 + k) * ld + col] : 0.f; }
            __syncthreads();
#pragma unroll
            for (int i = 0; i < 8; ++i) { const int rr = (tid >> 6) + 8 * i, k = tid & 63; dst[(size_t)(rt * 64 + rr) * K + kt * 64 + k] = f2bf(tile[k * 65 + rr]); }
        } else {
            const int t = it - NMOD - NTR, g = t / 33, tau = t % 33;
            f32x2* pw = (f32x2*)L;
            f32x2* ff = pw + 64;
            float* Cr = L + 256;
            float* Ci = Cr + 1024;
            float* bbr = Ci + 1024;
            float* bbi = bbr + 1024;
            if (tid < 64) {
                const double dt = exp((double)P->in[18][g]), ar = (double)P->in[16][g * 64 + tid], ai = (double)P->in[17][g * 64 + tid];
                double s, c; sincos_d((double)tau * dt * ai, s, c); const double mg = exp((double)tau * dt * ar);
                pw[tid] = (f32x2){(float)(mg * c), (float)(mg * s)};
                sincos_d(dt * ai, s, c); const double m1 = exp(dt * ar), abr = m1 * c, abi = m1 * s;
                const double den = ar * ar + ai * ai, nr = abr - 1.0, ni = abi;
                ff[tid] = (f32x2){(float)((nr * ar + ni * ai) / den), (float)((ni * ar - nr * ai) / den)};
            }
            for (int i = tid; i < 1024; i += 512) { Cr[i] = P->in[21][g * 1024 + i]; Ci[i] = P->in[22][g * 1024 + i]; }
            __syncthreads();
            for (int i = tid; i < 1024; i += 512) { const int p = i >> 4; const float br = P->in[19][g * 1024 + i], bi = P->in[20][g * 1024 + i]; const f32x2 f = ff[p];
                bbr[i] = f.x * br - f.y * bi; bbi[i] = f.x * bi + f.y * br; }
            __syncthreads();
            bf16_t* T = (bf16_t*)(ws + WS_S5T) + (size_t)g * 512 * 640;
            bf16_t* WS_ = (bf16_t*)(ws + WS_S5WS) + (size_t)g * 256 * 512;
            if (tau <= 31) {
                if (tid < 256) {
                    const int h = tid >> 4, h2 = tid & 15; float kv = 0.f;
                    for (int p = 0; p < 64; ++p) { const f32x2 w = pw[p]; const float cr = Cr[h * 64 + p], ci = Ci[h * 64 + p]; const float cpr = cr * w.x - ci * w.y, cpi = cr * w.y + ci * w.x;
                        kv += cpr * bbr[p * 16 + h2] - cpi * bbi[p * 16 + h2]; }
                    if (tau == 0 && h == h2) kv += P->in[23][g * 16 + h];
                    const bf16_t kb = f2bf(kv);
                    for (int s = 0; s + tau < 32; ++s) T[(size_t)((s + tau) * 16 + h) * 640 + s * 16 + h2] = kb;
                } else if (tau >= 1) {
                    const int h = (tid - 256) >> 4, h2 = tid & 15;
                    for (int l = 0; l + tau < 32; ++l) T[(size_t)(l * 16 + h) * 640 + (l + tau) * 16 + h2] = 0;
                }
                const int s = 31 - tau;
                for (int i = tid; i < 1024; i += 512) { const int p = i >> 4, h2 = i & 15; const f32x2 w = pw[p]; const float vr = w.x * bbr[i] - w.y * bbi[i], vi = w.x * bbi[i] + w.y * bbr[i];
                    WS_[(size_t)(2 * p) * 512 + s * 16 + h2] = f2bf(vr); WS_[(size_t)(2 * p + 1) * 512 + s * 16 + h2] = f2bf(vi); }
                for (int i = tid; i < 2048; i += 512) WS_[(size_t)(128 + (i >> 4)) * 512 + s * 16 + (i & 15)] = 0;
            }
            if (tau >= 1) {
                const int l = tau - 1;
                for (int i = tid; i < 1024; i += 512) { const int h = i >> 6, p = i & 63; const f32x2 w = pw[p]; const float cr = Cr[i], ci = Ci[i];
                    const unsigned pk = cvt_pk_bf16(cr * w.x - ci * w.y, -(cr * w.y + ci * w.x));
                    *(unsigned*)(T + (size_t)(l * 16 + h) * 640 + 512 + 2 * p) = pk; }
            }
            if (tau == 32 && tid < 64) ((f32x2*)(ws + WS_S5AL))[g * 64 + tid] = pw[tid];
        }
        __syncthreads();
    }
}

__device__ __forceinline__ void phase_mod_h(const float* x, const float* MOD, int shi, int sci, bf16_t* H) {
    const size_t n8 = (size_t)MT * DM / 8;
    for (size_t i = (size_t)blockIdx.x * 512 + threadIdx.x; i < n8; i += (size_t)gridDim.x * 512) {
        const size_t row = i >> 7; const int col = (int)(i & 127) * 8; const int b = (int)(row >> 12);
        const float* mp = MOD + (size_t)b * 9216 + col;
        const f32x4 a0 = *(const f32x4*)(x + row * DM + col), a1 = *(const f32x4*)(x + row * DM + col + 4);
        const f32x4 s0 = *(const f32x4*)(mp + sci * 1024), s1 = *(const f32x4*)(mp + sci * 1024 + 4), h0 = *(const f32x4*)(mp + shi * 1024), h1 = *(const f32x4*)(mp + shi * 1024 + 4);
        const f32x4 r0 = a0 * (s0 + 1.0f) + h0, r1 = a1 * (s1 + 1.0f) + h1;
        u32x4 w; w.x = cvt_pk_bf16(r0[0], r0[1]); w.y = cvt_pk_bf16(r0[2], r0[3]); w.z = cvt_pk_bf16(r1[0], r1[1]); w.w = cvt_pk_bf16(r1[2], r1[3]);
        *(u32x4*)(H + row * DM + col) = w;
    }
}

__device__ __forceinline__ void phase_ln(const float* Y, float* X, bf16_t* H, const float* lg, const float* lb, const float* MOD, int shi, int sci) {
    const int tl = tid_l(), lane = tl & 63, wv = tl >> 6;
    for (int row = blockIdx.x * 8 + wv; row < MT; row += gridDim.x * 8) {
        const float* y = Y + (size_t)row * DM;
        f32x4 v[4];
#pragma unroll
        for (int k = 0; k < 4; ++k) v[k] = *(const f32x4*)(y + 256 * k + 4 * lane);
        float s = 0.f;
#pragma unroll
        for (int k = 0; k < 4; ++k) s += (v[k][0] + v[k][1]) + (v[k][2] + v[k][3]);
        s = wave_sum(s); const float mu = s * (1.0f / 1024.0f);
        float q = 0.f;
#pragma unroll
        for (int k = 0; k < 4; ++k) { const f32x4 d = v[k] - mu; q += (d[0] * d[0] + d[1] * d[1]) + (d[2] * d[2] + d[3] * d[3]); }
        q = wave_sum(q); const float rstd = rsqrtf(q * (1.0f / 1024.0f) + LN_EPS);
        const float* mp = MOD + (size_t)(row >> 12) * 9216;
#pragma unroll
        for (int k = 0; k < 4; ++k) {
            const int col = 256 * k + 4 * lane;
            const f32x4 o = (v[k] - mu) * rstd * *(const f32x4*)(lg + col) + *(const f32x4*)(lb + col);
            *(f32x4*)(X + (size_t)row * DM + col) = o;
            if (H) { const f32x4 hh = o * (*(const f32x4*)(mp + sci * 1024 + col) + 1.0f) + *(const f32x4*)(mp + shi * 1024 + col);
                u32x2 w; w.x = cvt_pk_bf16(hh[0], hh[1]); w.y = cvt_pk_bf16(hh[2], hh[3]); *(u32x2*)(H + (size_t)row * DM + col) = w; }
        }
    }
}

constexpr int SP = 272;
constexpr int L_XT = 0, L_BM = 256 * SP, L_CM = L_BM + 128 * SP, L_ACS = L_CM + 128 * SP, L_DTS = L_ACS + 2048, L_TOT = L_DTS + 2048;
static_assert(L_TOT + 64 <= LDS_BYTES, "SSD LDS");

__device__ __forceinline__ void conv8(const bf16_t* XBC, const float* cw, const float* cb, size_t tok, int tin, int ch, float (&o)[8]) {
    const f32x4 b0 = *(const f32x4*)(cb + ch), b1 = *(const f32x4*)(cb + ch + 4);
    o[0] = b0[0]; o[1] = b0[1]; o[2] = b0[2]; o[3] = b0[3]; o[4] = b1[0]; o[5] = b1[1]; o[6] = b1[2]; o[7] = b1[3];
#pragma unroll
    for (int k = 0; k < 4; ++k) {
        if (tin - 3 + k >= 0) {
            const u32x4 xv = *(const u32x4*)(XBC + (tok - 3 + k) * 1024 + ch);
            const f32x4 w0 = *(const f32x4*)(cw + k * 1024 + ch), w1 = *(const f32x4*)(cw + k * 1024 + ch + 4);
            o[0] = fmaf(w0[0], bf_lo(xv.x), o[0]); o[1] = fmaf(w0[1], bf_hi(xv.x), o[1]); o[2] = fmaf(w0[2], bf_lo(xv.y), o[2]); o[3] = fmaf(w0[3], bf_hi(xv.y), o[3]);
            o[4] = fmaf(w1[0], bf_lo(xv.z), o[4]); o[5] = fmaf(w1[1], bf_hi(xv.z), o[5]); o[6] = fmaf(w1[2], bf_lo(xv.w), o[6]); o[7] = fmaf(w1[3], bf_hi(xv.w), o[7]);
        }
    }
#pragma unroll
    for (int i = 0; i < 8; ++i) o[i] = siluf(o[i]);
}

__device__ __forceinline__ void ssd_dt(KP P, unsigned char* lds, size_t t0, int gr) {
    const int tid = tid_l(), l = tid & 127, h = tid >> 7, head = 4 * gr + h, lane = tid & 63, w = tid >> 6;
    const float* DT = (const float*)(P->ws + WS_DT);
    float* ACS = (float*)(lds + L_ACS); float* DTS = (float*)(lds + L_DTS); float* TOT = (float*)(lds + L_TOT);
    const float raw = DT[(t0 + l) * 8 + head] + P->in[12][head];
    const float dtv = raw > 20.f ? raw : log1pf(expf(raw));
    float v = dtv * (-expf(P->in[13][head]));
#pragma unroll
    for (int d = 1; d < 64; d <<= 1) { const float t = __shfl_up(v, d); if (lane >= d) v += t; }
    if (lane == 63) TOT[w] = v;
    __syncthreads();
    if (w & 1) v += TOT[w - 1];
    ACS[h * 128 + l] = v; DTS[h * 128 + l] = dtv;
    __syncthreads();
}

__device__ __forceinline__ void ssd_pass1(KP P, unsigned char* lds) {
    const int tid = tid_l(), lane = tid & 63, w = __builtin_amdgcn_readfirstlane(tid >> 6), r = lane & 15, q = lane >> 4;
    const bf16_t* XBC = (const bf16_t*)(P->ws + WS_XBC);
    const float* cw = P->in[10]; const float* cb = P->in[11];
    float* STATES = (float*)((unsigned char*)P->out + OUT_STATES);
    float* CD = (float*)(P->ws + WS_CD);
    const float* ACS = (const float*)(lds + L_ACS); const float* DTS = (const float*)(lds + L_DTS);
    for (int un = blockIdx.x; un < 1024; un += gridDim.x) {
        const int gr = un & 1, bc = un >> 1, c = bc & 31; const size_t t0 = (size_t)bc * 128;
        ssd_dt(P, lds, t0, gr);
        if ((tid & 127) == 127) CD[bc * 8 + 4 * gr + (tid >> 7)] = __expf(ACS[(tid >> 7) * 128 + 127]);
        const int l = (w & 1) * 64 + lane, cp = w >> 1, tin = c * 128 + l;
#pragma unroll 1
        for (int oc = cp; oc < 32; oc += 4) {
            float o[8]; conv8(XBC, cw, cb, t0 + l, tin, 256 * gr + 8 * oc, o);
            const int h = oc >> 3; const float sc = DTS[h * 128 + l] * __expf(ACS[h * 128 + 127] - ACS[h * 128 + l]);
#pragma unroll
            for (int i = 0; i < 8; ++i) *(bf16_t*)(lds + L_XT + (8 * oc + i) * SP + l * 2) = f2bf(o[i] * sc);
        }
#pragma unroll 1
        for (int ob = cp; ob < 16; ob += 4) {
            float o[8]; conv8(XBC, cw, cb, t0 + l, tin, 512 + 128 * gr + 8 * ob, o);
#pragma unroll
            for (int i = 0; i < 8; ++i) *(bf16_t*)(lds + L_BM + (8 * ob + i) * SP + l * 2) = f2bf(o[i]);
        }
        __syncthreads();
        f32x4 acc[2][8];
#pragma unroll
        for (int a = 0; a < 2; ++a)
#pragma unroll
            for (int n = 0; n < 8; ++n) acc[a][n] = (f32x4){0.f, 0.f, 0.f, 0.f};
#pragma unroll
        for (int ks = 0; ks < 4; ++ks) {
            bf16x8 xf[2];
#pragma unroll
            for (int hf = 0; hf < 2; ++hf) xf[hf] = *(const bf16x8*)(lds + L_XT + (32 * w + 16 * hf + r) * SP + 64 * ks + 16 * q);
#pragma unroll
            for (int nf = 0; nf < 8; ++nf) { const bf16x8 bfr = *(const bf16x8*)(lds + L_BM + (16 * nf + r) * SP + 64 * ks + 16 * q);
#pragma unroll
                for (int hf = 0; hf < 2; ++hf) acc[hf][nf] = __builtin_amdgcn_mfma_f32_16x16x32_bf16(bfr, xf[hf], acc[hf][nf], 0, 0, 0); }
        }
#pragma unroll
        for (int hf = 0; hf < 2; ++hf) { const int hp = 32 * w + 16 * hf + r; float* sp = STATES + ((size_t)(bc * 8 + 4 * gr + (hp >> 6)) * 64 + (hp & 63)) * 128 + 4 * q;
#pragma unroll
            for (int nf = 0; nf < 8; ++nf) *(f32x4*)(sp + 16 * nf) = acc[hf][nf]; }
        __syncthreads();
    }
}

__device__ __forceinline__ void phase_scans(KP P) {
    const float* __restrict__ STATES = (const float*)((unsigned char*)P->out + OUT_STATES);
    bf16_t* __restrict__ PREV = (bf16_t*)((unsigned char*)P->out + OUT_PREV);
    const float* __restrict__ CD = (const float*)(P->ws + WS_CD);
    const size_t gsz = (size_t)gridDim.x * 512;
    for (size_t i = (size_t)blockIdx.x * 512 + threadIdx.x; i < 262144; i += gsz) {
        const int b = (int)(i >> 14), head = (int)(i >> 11) & 7, e4 = (int)(i & 2047) * 4;
        f32x4 h = (f32x4){0.f, 0.f, 0.f, 0.f};
#pragma unroll 8
        for (int c = 0; c < 32; ++c) {
            const size_t o = ((size_t)((b * 32 + c) * 8 + head)) * 8192 + e4;
            const f32x4 s = *(const f32x4*)(STATES + o); const float d = CD[(b * 32 + c) * 8 + head];
            u32x2 wv; wv.x = cvt_pk_bf16(h[0], h[1]); wv.y = cvt_pk_bf16(h[2], h[3]); *(u32x2*)(PREV + o) = wv;
            h = h * d + s;
        }
    }
    const f32x2* __restrict__ S = (const f32x2*)(P->ws + WS_S5S);
    const f32x2* __restrict__ AL = (const f32x2*)(P->ws + WS_S5AL);
    bf16_t* __restrict__ UX = (bf16_t*)(P->ws + WS_UX);
    for (size_t i = (size_t)blockIdx.x * 512 + threadIdx.x; i < 32768; i += gsz) {
        const int g = (int)(i >> 10), b = (int)(i >> 6) & 15, p = (int)(i & 63);
        const f32x2 al = AL[g * 64 + p]; float xr = 0.f, xi = 0.f;
#pragma unroll 8
        for (int c = 0; c < 128; ++c) {
            const size_t rc = (size_t)g * 2048 + b * 128 + c;
            const f32x2 s = S[rc * 64 + p];
            *(unsigned*)(UX + rc * 640 + 512 + 2 * p) = cvt_pk_bf16(xr, xi);
            const float nr = al.x * xr - al.y * xi + s.x, ni = al.x * xi + al.y * xr + s.y; xr = nr; xi = ni;
        }
    }
}

__device__ __forceinline__ void ssd_pass2(KP P, unsigned char* lds) {
    const int tid = tid_l(), lane = tid & 63, w = __builtin_amdgcn_readfirstlane(tid >> 6), r = lane & 15, q = lane >> 4;
    const bf16_t* XBC = (const bf16_t*)(P->ws + WS_XBC);
    const bf16_t* Z = (const bf16_t*)(P->ws + WS_Z);
    const bf16_t* PREV = (const bf16_t*)((unsigned char*)P->out + OUT_PREV);
    bf16_t* YC = (bf16_t*)(P->ws + WS_H);
    const float* cw = P->in[10]; const float* cb = P->in[11];
    const float* ACS = (const float*)(lds + L_ACS); const float* DTS = (const float*)(lds + L_DTS);
    for (int un = blockIdx.x; un < 1024; un += gridDim.x) {
        const int gr = un & 1, bc = un >> 1, c = bc & 31; const size_t t0 = (size_t)bc * 128;
        ssd_dt(P, lds, t0, gr);
        {
            const int l = (w & 1) * 64 + lane, cp = w >> 1, tin = c * 128 + l;
    #pragma unroll 1
        for (int oc = cp; oc < 32; oc += 4) {
                float o[8]; conv8(XBC, cw, cb, t0 + l, tin, 256 * gr + 8 * oc, o);
#pragma unroll
                for (int i = 0; i < 8; ++i) *(bf16_t*)(lds + L_XT + (8 * oc + i) * SP + l * 2) = f2bf(o[i]);
            }
    #pragma unroll 1
        for (int ob = cp; ob < 16; ob += 4) {
                float o[8]; conv8(XBC, cw, cb, t0 + l, tin, 512 + 128 * gr + 8 * ob, o);
                u32x4 wv; wv.x = cvt_pk_bf16(o[0], o[1]); wv.y = cvt_pk_bf16(o[2], o[3]); wv.z = cvt_pk_bf16(o[4], o[5]); wv.w = cvt_pk_bf16(o[6], o[7]);
                *(u32x4*)(lds + L_BM + l * SP + 16 * ob) = wv;
            }
    #pragma unroll 1
        for (int ob = cp; ob < 16; ob += 4) {
                float o[8]; conv8(XBC, cw, cb, t0 + l, tin, 768 + 128 * gr + 8 * ob, o);
                u32x4 wv; wv.x = cvt_pk_bf16(o[0], o[1]); wv.y = cvt_pk_bf16(o[2], o[3]); wv.z = cvt_pk_bf16(o[4], o[5]); wv.w = cvt_pk_bf16(o[6], o[7]);
                *(u32x4*)(lds + L_CM + l * SP + 16 * ob) = wv;
            }
        }
        __syncthreads();
        bf16x8 cfr[4];
#pragma unroll
        for (int ks = 0; ks < 4; ++ks) cfr[ks] = *(const bf16x8*)(lds + L_CM + (16 * w + r) * SP + 64 * ks + 16 * q);
        f32x4 cbt[8];
#pragma unroll
        for (int sf = 0; sf < 8; ++sf) { f32x4 a = (f32x4){0.f, 0.f, 0.f, 0.f};
#pragma unroll
            for (int ks = 0; ks < 4; ++ks) { const bf16x8 bfr = *(const bf16x8*)(lds + L_BM + (16 * sf + r) * SP + 64 * ks + 16 * q); a = __builtin_amdgcn_mfma_f32_16x16x32_bf16(bfr, cfr[ks], a, 0, 0, 0); }
            cbt[sf] = a; __builtin_amdgcn_sched_barrier(0); }
        const int lrow = 16 * w + r;
        f32x4 ssq = (f32x4){0.f, 0.f, 0.f, 0.f};
#pragma unroll 1
        for (int h = 0; h < 4; ++h) {
            const float acs_l = ACS[h * 128 + lrow];
            bf16x8 mfr[4];
#pragma unroll
            for (int i = 0; i < 4; ++i) {
                float mv[8];
#pragma unroll
                for (int hf = 0; hf < 2; ++hf) { const int sf = 2 * i + hf, s0 = 16 * sf + 4 * q;
                    const f32x4 as = *(const f32x4*)(ACS + h * 128 + s0), ds = *(const f32x4*)(DTS + h * 128 + s0);
#pragma unroll
                    for (int j = 0; j < 4; ++j) mv[hf * 4 + j] = (s0 + j <= lrow) ? cbt[sf][j] * __expf(acs_l - as[j]) * ds[j] : 0.f; }
                u32x4 pk; pk.x = cvt_pk_bf16(mv[0], mv[1]); pk.y = cvt_pk_bf16(mv[2], mv[3]); pk.z = cvt_pk_bf16(mv[4], mv[5]); pk.w = cvt_pk_bf16(mv[6], mv[7]);
                mfr[i] = __builtin_bit_cast(bf16x8, pk);
            }
            const int head = 4 * gr + h;
            const float Dh = P->in[14][head];
            const f32x4 a4 = *(const f32x4*)(ACS + h * 128 + 16 * w + 4 * q);
            const f32x4 ea = (f32x4){__expf(a4[0]), __expf(a4[1]), __expf(a4[2]), __expf(a4[3])};
#pragma unroll 1
            for (int pf = 0; pf < 4; ++pf) {
                const int xrow = h * 64 + 16 * pf + r;
                f32x4 ay = (f32x4){0.f, 0.f, 0.f, 0.f}, ao = (f32x4){0.f, 0.f, 0.f, 0.f};
#pragma unroll
                for (int i = 0; i < 4; ++i) {
                    const u32x2 lo = *(const u32x2*)(lds + L_XT + xrow * SP + 64 * i + 8 * q), hi = *(const u32x2*)(lds + L_XT + xrow * SP + 64 * i + 32 + 8 * q);
                    const u32x4 xx = (u32x4){lo.x, lo.y, hi.x, hi.y};
                    ay = __builtin_amdgcn_mfma_f32_16x16x32_bf16(mfr[i], __builtin_bit_cast(bf16x8, xx), ay, 0, 0, 0);
                }
                const bf16_t* pp = PREV + ((size_t)(bc * 8 + head) * 64 + 16 * pf + r) * 128 + 8 * q;
#pragma unroll
                for (int ks = 0; ks < 4; ++ks) { const bf16x8 pfr = *(const bf16x8*)(pp + 32 * ks); ao = __builtin_amdgcn_mfma_f32_16x16x32_bf16(cfr[ks], pfr, ao, 0, 0, 0); }
                const u32x2 xs = *(const u32x2*)(lds + L_XT + xrow * SP + (16 * w + 4 * q) * 2);
                const float xf[4] = {bf_lo(xs.x), bf_hi(xs.x), bf_lo(xs.y), bf_hi(xs.y)};
                const int ch = 256 * gr + 64 * h + 16 * pf + r;
                const bf16_t* zp = Z + (t0 + 16 * w + 4 * q) * 512 + ch;
                bf16_t* yp = YC + (t0 + 16 * w + 4 * q) * 1024 + ch;
#pragma unroll
                for (int j = 0; j < 4; ++j) { const float zz = __uint_as_float((unsigned)zp[(size_t)j * 512] << 16); const float t = (ay[j] + ea[j] * ao[j] + Dh * xf[j]) * siluf(zz);
                    const bf16_t tb = f2bf(t); yp[(size_t)j * 1024] = tb; const float tr = __uint_as_float((unsigned)tb << 16); ssq[j] += tr * tr; }
            }
        }
#pragma unroll
        for (int j = 0; j < 4; ++j) { float s = ssq[j]; s += __shfl_xor(s, 1); s += __shfl_xor(s, 2); s += __shfl_xor(s, 4); s += __shfl_xor(s, 8); ssq[j] = rsqrtf(s * (1.0f / 256.0f) + LN_EPS); }
#pragma unroll 1
        for (int hp = 0; hp < 16; ++hp) { const int ch = 256 * gr + 16 * hp + r; const float nw = P->in[15][ch];
            bf16_t* yp = YC + (t0 + 16 * w + 4 * q) * 1024 + ch;
#pragma unroll
            for (int j = 0; j < 4; ++j) { const float t = __uint_as_float((unsigned)yp[(size_t)j * 1024] << 16); yp[(size_t)j * 1024] = f2bf(t * ssq[j] * nw); } }
        __syncthreads();
    }
}

__global__ void __launch_bounds__(512, 2) mega(Params Pv) {
    extern __shared__ __attribute__((aligned(16))) unsigned char lds[];
    cg::grid_group grid = cg::this_grid();
    const KP P0 = (KP)__builtin_amdgcn_kernarg_segment_ptr();
#define P launder(P0)
    unsigned char* ws = P->ws;
    LAS unsigned char* ldsl = (LAS unsigned char*)lds;
    const float* MOD = (const float*)(ws + WS_MOD);
    bf16_t* H = (bf16_t*)(ws + WS_H); bf16_t* ACT = (bf16_t*)(ws + WS_ACT); float* X = (float*)(ws + WS_X);
    float* Y = P->out;

    phase0(P, (float*)lds);
    grid.sync();
    phase_mod_h(P->in[0], MOD, 0, 1, H);
    grid.sync();
    { pg8::Gemm g{H, (const bf16_t*)(ws + WS_W13A), 1024, 1024, 1024, 256, 22, 1, 0, 0}; pg8::EpiSwiGLU E{ACT}; pg8::gemm_phase(ldsl, g, E); }
    grid.sync();
    { pg8::Gemm g{ACT, (const bf16_t*)(ws + WS_W2A), 2816, 2816, 2816, 256, 4, 1, 0, 0}; pg8::EpiResid E{Y, P->in[0], MOD + 2 * 1024, 0.5f}; pg8::gemm_phase(ldsl, g, E); }
    grid.sync();
    phase_ln(Y, X, H, P->in[7], P->in[8], MOD, 3, 4);
    grid.sync();
    { pg8::Gemm g{H, (const bf16_t*)(ws + WS_WIN), 1024, 1024, 1024, 256, 9, 1, 0, 0};
      pg8::EpiInProj E{(bf16_t*)(ws + WS_Z), (bf16_t*)(ws + WS_XBC), (bf16_t*)(ws + WS_UX), (float*)(ws + WS_DT)}; pg8::gemm_phase(ldsl, g, E); }
    grid.sync();
    ssd_pass1(P, lds);
    { pg8::Gemm g{(const bf16_t*)(ws + WS_UX), (const bf16_t*)(ws + WS_S5WS), 640, 512, 512, 8, 1, 32, 2048ull * 640, 256ull * 512}; pg8::EpiS5S E{(float*)(ws + WS_S5S)}; pg8::gemm_phase(ldsl, g, E); }
    grid.sync();
    phase_scans(P);
    grid.sync();
    ssd_pass2(P, lds);
    { pg8::Gemm g{(const bf16_t*)(ws + WS_UX), (const bf16_t*)(ws + WS_S5T), 640, 640, 640, 8, 2, 32, 2048ull * 640, 512ull * 640}; pg8::EpiS5Main E{(bf16_t*)(ws + WS_G)}; pg8::gemm_phase(ldsl, g, E); }
    grid.sync();
    { pg8::Gemm g{(const bf16_t*)(ws + WS_G), (const bf16_t*)(ws + WS_WGLU), 512, 512, 512, 256, 2, 1, 0, 0}; pg8::EpiGLU E{(const bf16_t*)(ws + WS_G), P->in[25], H}; pg8::gemm_phase(ldsl, g, E); }
    grid.sync();
    { pg8::Gemm g{H, (const bf16_t*)(ws + WS_WOUT), 1024, 1024, 1024, 256, 4, 1, 0, 0}; pg8::EpiResid E{Y, X, MOD + 5 * 1024, 1.0f}; pg8::gemm_phase(ldsl, g, E); }
    grid.sync();
    phase_ln(Y, X, H, P->in[27], P->in[28], MOD, 6, 7);
    grid.sync();
    { pg8::Gemm g{H, (const bf16_t*)(ws + WS_W13B), 1024, 1024, 1024, 256, 22, 1, 0, 0}; pg8::EpiSwiGLU E{ACT}; pg8::gemm_phase(ldsl, g, E); }
    grid.sync();
    { pg8::Gemm g{ACT, (const bf16_t*)(ws + WS_W2B), 2816, 2816, 2816, 256, 4, 1, 0, 0}; pg8::EpiResid E{Y, X, MOD + 8 * 1024, 0.5f}; pg8::gemm_phase(ldsl, g, E); }
    grid.sync();
    phase_ln(Y, Y, nullptr, P->in[32], P->in[33], MOD, 0, 0);
#undef P
}

extern "C" void kernel_launch(void* const* d_in, const int* in_sizes, int n_in, void* d_out, int out_size, void* d_ws, size_t ws_size, hipStream_t stream) {
    static int grid = 0;
    if (grid == 0) {
        int dev = 0, cus = 0, per_cu = 0;
        (void)hipGetDevice(&dev);
        (void)hipDeviceGetAttribute(&cus, hipDeviceAttributeMultiprocessorCount, dev);
        if (hipFuncSetAttribute((const void*)mega, hipFuncAttributeMaxDynamicSharedMemorySize, LDS_BYTES) != hipSuccess) fprintf(stderr, "kernel_launch: hipFuncSetAttribute failed\n");
        if (hipOccupancyMaxActiveBlocksPerMultiprocessor(&per_cu, (const void*)mega, 512, LDS_BYTES) != hipSuccess || per_cu < 1) { fprintf(stderr, "kernel_launch: occupancy query gave %d\n", per_cu); per_cu = 1; }
        (void)hipGetLastError();
        grid = cus * per_cu;
        if (ws_size < WS_END) fprintf(stderr, "kernel_launch: workspace too small: %zu < %zu\n", ws_size, (size_t)WS_END);
    }
    Params p{};
    for (int i = 0; i < 34; ++i) p.in[i] = (const float*)d_in[i];
    p.out = (float*)d_out; p.ws = (unsigned char*)d_ws;
    void* args[] = {&p};
    hipError_t e = hipLaunchCooperativeKernel((const void*)mega, dim3(grid), dim3(512), args, LDS_BYTES, stream);
    if (e != hipSuccess) fprintf(stderr, "kernel_launch: cooperative launch failed: %s (grid %d)\n", hipGetErrorString(e), grid);
}
```
